# Optimizing an MI355X kernel written in HIP

```python
import math
import jax, jax.numpy as jnp
from jax import lax
import numpy as np

D_MODEL = 1024
BATCH = 8
SEQ = 2048
DEPTH = 1

HEAD_DIM = 64
DIL_CONFIGS = ((128, 1), (512, 4), (2048, 16))
N_DIL_GROUPS = len(DIL_CONFIGS)
DIL_HEADS_PER_GROUP = 4
N_DIL_HEADS = N_DIL_GROUPS * DIL_HEADS_PER_GROUP
N_FOX_HEADS = 8
BLOCK = 128
ROPE_THETA = 500000.0
ROPE_DIM = HEAD_DIM // 4
D_FF = -(-(8 * D_MODEL) // (3 * 256)) * 256
EPS = 1e-6
NEG_INF = -1e30

DIL_WIDTH = N_DIL_HEADS * HEAD_DIM
DIL_OUT_WIDTH = DIL_HEADS_PER_GROUP * HEAD_DIM
FOX_WIDTH = N_FOX_HEADS * HEAD_DIM
IN_SPLITS = (DIL_WIDTH, DIL_WIDTH, DIL_WIDTH, FOX_WIDTH, FOX_WIDTH, FOX_WIDTH,
             N_FOX_HEADS, D_MODEL, D_MODEL)
IN_COLS = sum(IN_SPLITS)

kernel_name = "hybrid_dilated_fox_gated_block"


def rmsnorm(x, gain):
    xf = x.astype(jnp.float32)
    y = xf * lax.rsqrt(jnp.mean(xf * xf, axis=-1, keepdims=True) + EPS)
    return (y * gain.astype(jnp.float32)).astype(x.dtype)


def partial_rope(x, positions):
    half = ROPE_DIM // 2
    inv_freq = jnp.power(ROPE_THETA, -jnp.arange(0, ROPE_DIM, 2, dtype=jnp.float32) / ROPE_DIM)
    ang = positions[:, None] * inv_freq[None, :]
    cos = jnp.cos(ang)[None, :, None, :].astype(x.dtype)
    sin = jnp.sin(ang)[None, :, None, :].astype(x.dtype)
    x1, x2, rest = x[..., :half], x[..., half:ROPE_DIM], x[..., ROPE_DIM:]
    return jnp.concatenate([x1 * cos - x2 * sin, x2 * cos + x1 * sin, rest], axis=-1)


def dilated_window_attention(q, k, v, window, dilation):
    B, S, H, Dh = q.shape
    steps = window // dilation
    span = dilation * BLOCK
    s_pad = -(-S // span) * span
    L = s_pad // dilation
    nb = L // BLOCK

    def to_blocks(t):
        t = jnp.pad(t, ((0, 0), (0, s_pad - S), (0, 0), (0, 0)))
        t = t.reshape(B, L, dilation, H, Dh).transpose(0, 2, 1, 3, 4)
        return t.reshape(B * dilation, nb, BLOCK, H, Dh)

    qb, kb, vb = to_blocks(q), to_blocks(k), to_blocks(v)

    def with_prev(t):
        prev = jnp.pad(t[:, :-1], ((0, 0), (1, 0), (0, 0), (0, 0), (0, 0)))
        return jnp.concatenate([prev, t], axis=2)

    kc, vc = with_prev(kb), with_prev(vb)
    scale = 1.0 / math.sqrt(Dh)
    scores = jnp.einsum('znqhd,znkhd->znhqk', qb, kc).astype(jnp.float32) * scale
    qi = jnp.arange(BLOCK)[:, None]
    kj = jnp.arange(2 * BLOCK)[None, :]
    rel = qi + BLOCK - kj
    blk = jnp.arange(nb)[:, None, None]
    valid = (rel >= 0) & (rel <= steps) & (blk * BLOCK + kj - BLOCK >= 0)
    scores = jnp.where(valid[None, :, None, :, :], scores, NEG_INF)
    m = jnp.max(scores, axis=-1, keepdims=True)
    p = jnp.exp(scores - m)
    den = jnp.sum(p, axis=-1, keepdims=True)
    out = jnp.einsum('znhqk,znkhd->znqhd', (p / den).astype(v.dtype), vc)
    lse = (m + jnp.log(den))[..., 0].transpose(0, 1, 3, 2)

    def from_blocks(t):
        t = t.reshape((B, dilation, L) + t.shape[3:])
        t = jnp.moveaxis(t, 1, 2).reshape((B, s_pad) + t.shape[3:])
        return t[:, :S]

    return from_blocks(out), from_blocks(lse)


def forgetting_attention(q, k, v, log_f):
    B, S, H, Dh = q.shape
    F = jnp.cumsum(log_f.astype(jnp.float32), axis=1).transpose(0, 2, 1)
    scale = 1.0 / math.sqrt(Dh)
    outs = []
    for n in range(S // BLOCK):
        lo, hi = n * BLOCK, (n + 1) * BLOCK
        s = jnp.einsum('bqhd,bkhd->bhqk', q[:, lo:hi], k[:, :hi]).astype(jnp.float32) * scale
        s = s + (F[:, :, lo:hi, None] - F[:, :, None, :hi])
        causal = jnp.arange(lo, hi)[:, None] >= jnp.arange(hi)[None, :]
        s = jnp.where(causal[None, None], s, NEG_INF)
        p = jax.nn.softmax(s, axis=-1)
        outs.append(jnp.einsum('bhqk,bkhd->bqhd', p.astype(v.dtype), v[:, :hi]))
    return jnp.concatenate(outs, axis=1)


def token_mixer(h, w_in, w_proj_a, w_proj_b, w_out, b_forget):
    B, S, _ = h.shape
    proj = h @ w_in
    idx = list(np.cumsum(IN_SPLITS)[:-1])
    qa, ka, va, qb, kb, vb, f_logit, g_a, g_b = jnp.split(proj, idx, axis=-1)
    positions = jnp.arange(S, dtype=jnp.float32)

    qa = partial_rope(qa.reshape(B, S, N_DIL_HEADS, HEAD_DIM), positions)
    ka = partial_rope(ka.reshape(B, S, N_DIL_HEADS, HEAD_DIM), positions)
    va = va.reshape(B, S, N_DIL_HEADS, HEAD_DIM)
    group_out, group_lse = [], []
    for g, (window, dilation) in enumerate(DIL_CONFIGS):
        sl = slice(g * DIL_HEADS_PER_GROUP, (g + 1) * DIL_HEADS_PER_GROUP)
        o, lse = dilated_window_attention(qa[:, :, sl], ka[:, :, sl], va[:, :, sl], window, dilation)
        group_out.append(o)
        group_lse.append(lse)
    w_groups = jax.nn.softmax(jnp.stack(group_lse, axis=0), axis=0)
    out_a = jnp.sum(w_groups[..., None].astype(h.dtype) * jnp.stack(group_out, axis=0), axis=0)
    out_a = out_a.reshape(B, S, DIL_OUT_WIDTH)

    log_f = jax.nn.log_sigmoid((f_logit + b_forget).astype(jnp.float32))
    out_b = forgetting_attention(qb.reshape(B, S, N_FOX_HEADS, HEAD_DIM),
                                 kb.reshape(B, S, N_FOX_HEADS, HEAD_DIM),
                                 vb.reshape(B, S, N_FOX_HEADS, HEAD_DIM), log_f)
    out_b = out_b.reshape(B, S, FOX_WIDTH)

    merged = jax.nn.sigmoid(g_a) * (out_a @ w_proj_a) + jax.nn.sigmoid(g_b) * (out_b @ w_proj_b)
    return merged @ w_out


def swiglu(h, w_gate, w_up, w_down):
    return (jax.nn.silu(h @ w_gate) * (h @ w_up)) @ w_down


def setup_inputs(seed: int = 0) -> dict:
    key = jax.random.key(seed)
    ks = jax.random.split(key, 14)
    f32 = jnp.float32

    def dense(k, fan_in, fan_out):
        return jax.random.normal(k, (DEPTH, fan_in, fan_out), f32) * fan_in ** -0.5

    def gain(k):
        return 1.0 + 0.05 * jax.random.normal(k, (DEPTH, D_MODEL), f32)

    return {
        "x": jax.random.normal(ks[0], (BATCH, SEQ, D_MODEL), f32),
        "w_in": dense(ks[1], D_MODEL, IN_COLS),
        "w_proj_a": dense(ks[2], DIL_OUT_WIDTH, D_MODEL),
        "w_proj_b": dense(ks[3], FOX_WIDTH, D_MODEL),
        "w_out": dense(ks[4], D_MODEL, D_MODEL),
        "b_forget": jax.random.uniform(ks[5], (DEPTH, N_FOX_HEADS), f32, minval=1.0, maxval=5.0),
        "w_ffn_gate": dense(ks[6], D_MODEL, D_FF),
        "w_ffn_up": dense(ks[7], D_MODEL, D_FF),
        "w_ffn_down": dense(ks[8], D_FF, D_MODEL),
        "norm_mix_pre": gain(ks[9]),
        "norm_mix_post": gain(ks[10]),
        "norm_ffn_pre": gain(ks[11]),
        "norm_ffn_post": gain(ks[12]),
    }


def reference(x, w_in, w_proj_a, w_proj_b, w_out, b_forget, w_ffn_gate, w_ffn_up, w_ffn_down,
              norm_mix_pre, norm_mix_post, norm_ffn_pre, norm_ffn_post):
    for layer in range(DEPTH):
        h = rmsnorm(x, norm_mix_pre[layer])
        mix = token_mixer(h, w_in[layer], w_proj_a[layer], w_proj_b[layer], w_out[layer], b_forget[layer])
        x = x + rmsnorm(mix, norm_mix_post[layer])
        h = rmsnorm(x, norm_ffn_pre[layer])
        ff = swiglu(h, w_ffn_gate[layer], w_ffn_up[layer], w_ffn_down[layer])
        x = x + rmsnorm(ff, norm_ffn_post[layer])
    return x
```

```cpp
#include <hip/hip_runtime.h>
#include <cstdio>
#include <cstdint>

#define DM 1024
#define NB 8
#define SEQ 2048
#define HD 64
#define DFF 2816
#define INC 5896
#define O_QA 0
#define O_KA 768
#define O_VA 1536
#define O_QB 2304
#define O_KB 2816
#define O_VB 3328
#define O_F 3840
#define O_GA 3848
#define O_GB 4872

__device__ __forceinline__ float wave_sum(float v) {
#pragma unroll
    for (int o = 1; o < 64; o <<= 1) v += __shfl_xor(v, o);
    return v;
}
__device__ __forceinline__ float wave_max(float v) {
#pragma unroll
    for (int o = 1; o < 64; o <<= 1) v = fmaxf(v, __shfl_xor(v, o));
    return v;
}

__global__ void k_rope_table(float* cs, float* sn) {
    const int idx = blockIdx.x * blockDim.x + threadIdx.x;
    if (idx >= SEQ * 8) return;
    const int s = idx >> 3, i = idx & 7;
    const float invf[8] = {1.0f, 0.19392274474868576f, 0.03760603093086393f, 0.007292664737217109f,
                           0.001414213562373095f, 0.0002742481756762073f, 5.318295896944988e-05f, 1.031338537721246e-05f};
    float fr = 1.0f;
#pragma unroll
    for (int j = 0; j < 8; ++j) if (j == i) fr = invf[j];
    const float angf = (float)s * fr;
    const double x = (double)angf;
    const double TWO_PI = 6.283185307179586476925286766559;
    const double n = rint(x / TWO_PI);
    double r = x - n * TWO_PI;
    const double HALF_PI = 1.5707963267948966192313216916398;
    const double kq = rint(r / HALF_PI);
    const double y = r - kq * HALF_PI;
    const double y2 = y * y;
    double sy = y * (1.0 + y2 * (-1.0 / 6 + y2 * (1.0 / 120 + y2 * (-1.0 / 5040 + y2 * (1.0 / 362880 + y2 * (-1.0 / 39916800 + y2 * (1.0 / 6227020800.0)))))));
    double cy = 1.0 + y2 * (-0.5 + y2 * (1.0 / 24 + y2 * (-1.0 / 720 + y2 * (1.0 / 40320 + y2 * (-1.0 / 3628800 + y2 * (1.0 / 479001600.0 + y2 * (-1.0 / 87178291200.0)))))));
    int q = ((int)kq) & 3;
    double c, s_;
    if (q == 0) { c = cy; s_ = sy; } else if (q == 1) { c = -sy; s_ = cy; } else if (q == 2) { c = -cy; s_ = -sy; } else { c = sy; s_ = -cy; }
    cs[idx] = (float)c; sn[idx] = (float)s_;
}

__global__ void k_rmsnorm(const float* x, const float* gain, const float* res, float* out, int rows) {
    const int row = blockIdx.x * (blockDim.x / 64) + threadIdx.x / 64; const int lane = threadIdx.x & 63;
    if (row >= rows) return;
    const float* xr = x + (size_t)row * DM;
    float v[16]; float ss = 0.f;
#pragma unroll
    for (int j = 0; j < 16; ++j) { v[j] = xr[lane + 64 * j]; ss += v[j] * v[j]; }
    ss = wave_sum(ss);
    const float rs = 1.0f / sqrtf(ss * (1.0f / DM) + 1e-6f);
#pragma unroll
    for (int j = 0; j < 16; ++j) { float y = v[j] * rs * gain[lane + 64 * j]; if (res) y += res[(size_t)row * DM + lane + 64 * j]; out[(size_t)row * DM + lane + 64 * j] = y; }
}

__global__ void __launch_bounds__(256) k_gemm(const float* __restrict__ A, const float* __restrict__ W, float* __restrict__ C, int M, int N, int K) {
    __shared__ float As[16][68];
    __shared__ float Ws[16][68];
    const int tid = threadIdx.x, tx = tid & 15, ty = tid >> 4;
    const int m0 = blockIdx.y * 64, n0 = blockIdx.x * 64;
    float acc[4][4];
#pragma unroll
    for (int i = 0; i < 4; ++i)
#pragma unroll
        for (int j = 0; j < 4; ++j) acc[i][j] = 0.f;
    const int arow = tid >> 2, akk = (tid & 3) * 4;
    const int wkk = tid >> 4, wn = (tid & 15) * 4;
    for (int k0 = 0; k0 < K; k0 += 16) {
        const float4 a = *(const float4*)(A + (size_t)(m0 + arow) * K + k0 + akk);
        As[akk + 0][arow] = a.x; As[akk + 1][arow] = a.y; As[akk + 2][arow] = a.z; As[akk + 3][arow] = a.w;
        float4 w = make_float4(0.f, 0.f, 0.f, 0.f);
        if (n0 + wn < N) w = *(const float4*)(W + (size_t)(k0 + wkk) * N + n0 + wn);
        Ws[wkk][wn + 0] = w.x; Ws[wkk][wn + 1] = w.y; Ws[wkk][wn + 2] = w.z; Ws[wkk][wn + 3] = w.w;
        __syncthreads();
#pragma unroll
        for (int kk = 0; kk < 16; ++kk) {
            float av[4], bv[4];
#pragma unroll
            for (int i = 0; i < 4; ++i) av[i] = As[kk][ty * 4 + i];
#pragma unroll
            for (int j = 0; j < 4; ++j) bv[j] = Ws[kk][tx * 4 + j];
#pragma unroll
            for (int i = 0; i < 4; ++i)
#pragma unroll
                for (int j = 0; j < 4; ++j) acc[i][j] += av[i] * bv[j];
        }
        __syncthreads();
    }
    if (n0 + tx * 4 < N) {
#pragma unroll
        for (int i = 0; i < 4; ++i) *(float4*)(C + (size_t)(m0 + ty * 4 + i) * N + n0 + tx * 4) = make_float4(acc[i][0], acc[i][1], acc[i][2], acc[i][3]);
    }
}

__global__ void k_rope(float* proj, const float* cs, const float* sn) {
    const int idx = blockIdx.x * blockDim.x + threadIdx.x;
    if (idx >= SEQ * 24 * 8) return;
    const int i = idx & 7, hh = (idx >> 3) % 24, s = idx / (24 * 8);
    const int col = (hh < 12 ? O_QA + hh * 64 : O_KA + (hh - 12) * 64);
    float* p = proj + (size_t)s * INC + col;
    const float x1 = p[i], x2 = p[i + 8], c = cs[s * 8 + i], sv = sn[s * 8 + i];
    p[i] = x1 * c - x2 * sv; p[i + 8] = x2 * c + x1 * sv;
}

__global__ void k_logf_cumsum(const float* proj, const float* bforget, float* F) {
    const int h = blockIdx.x, lane = threadIdx.x;
    float carry = 0.f;
    for (int s0 = 0; s0 < SEQ; s0 += 64) {
        const float z = proj[(size_t)(s0 + lane) * INC + O_F + h] + bforget[h];
        float v = fminf(z, 0.f) - log1pf(expf(-fabsf(z)));
#pragma unroll
        for (int o = 1; o < 64; o <<= 1) { const float t = __shfl_up(v, o); if (lane >= o) v += t; }
        v += carry;
        F[(size_t)(s0 + lane) * 8 + h] = v;
        carry = __shfl(v, 63);
    }
}

__global__ void __launch_bounds__(64) k_dil_attn(const float* proj, float* oA, float* lseA) {
    __shared__ float qs[64];
    __shared__ float sc[132];
    const int t = blockIdx.x, head = blockIdx.y, lane = threadIdx.x;
    const int g = head >> 2, dil = (g == 0 ? 1 : (g == 1 ? 4 : 16));
    const int psub = t / dil;
    const int nk = (psub < 128 ? psub : 128) + 1;
    qs[lane] = proj[(size_t)t * INC + O_QA + head * 64 + lane];
    __syncthreads();
    float mx = -3.0e38f;
    for (int j = lane; j < nk; j += 64) {
        const float* kr = proj + (size_t)(t - j * dil) * INC + O_KA + head * 64;
        float d = 0.f;
        for (int e = 0; e < 64; e += 4) { const float4 kv = *(const float4*)(kr + e); d += qs[e] * kv.x + qs[e + 1] * kv.y + qs[e + 2] * kv.z + qs[e + 3] * kv.w; }
        d *= 0.125f; sc[j] = d; mx = fmaxf(mx, d);
    }
    mx = wave_max(mx);
    float den = 0.f;
    for (int j = lane; j < nk; j += 64) { const float p = expf(sc[j] - mx); sc[j] = p; den += p; }
    den = wave_sum(den);
    __syncthreads();
    float o = 0.f;
    for (int j = 0; j < nk; ++j) o += (sc[j] / den) * proj[(size_t)(t - j * dil) * INC + O_VA + head * 64 + lane];
    oA[((size_t)g * SEQ + t) * 256 + (head & 3) * 64 + lane] = o;
    if (lane == 0) lseA[((size_t)g * SEQ + t) * 4 + (head & 3)] = mx + logf(den);
}

__global__ void k_merge_a(const float* oA, const float* lseA, float* outA) {
    const int idx = blockIdx.x * blockDim.x + threadIdx.x;
    if (idx >= SEQ * 256) return;
    const int t = idx >> 8, c = idx & 255, j = c >> 6;
    const float l0 = lseA[((size_t)0 * SEQ + t) * 4 + j], l1 = lseA[((size_t)1 * SEQ + t) * 4 + j], l2 = lseA[((size_t)2 * SEQ + t) * 4 + j];
    const float m = fmaxf(l0, fmaxf(l1, l2));
    const float e0 = expf(l0 - m), e1 = expf(l1 - m), e2 = expf(l2 - m), inv = 1.0f / (e0 + e1 + e2);
    outA[idx] = (e0 * inv) * oA[((size_t)0 * SEQ + t) * 256 + c] + (e1 * inv) * oA[((size_t)1 * SEQ + t) * 256 + c] + (e2 * inv) * oA[((size_t)2 * SEQ + t) * 256 + c];
}

__global__ void __launch_bounds__(64) k_fox_attn(const float* proj, const float* F, float* outB) {
    __shared__ float qs[64];
    __shared__ float sc[SEQ];
    const int t = blockIdx.x, h = blockIdx.y, lane = threadIdx.x;
    qs[lane] = proj[(size_t)t * INC + O_QB + h * 64 + lane];
    __syncthreads();
    const float Ft = F[(size_t)t * 8 + h];
    float mx = -3.0e38f;
    for (int k = lane; k <= t; k += 64) {
        const float* kr = proj + (size_t)k * INC + O_KB + h * 64;
        float d = 0.f;
        for (int e = 0; e < 64; e += 4) { const float4 kv = *(const float4*)(kr + e); d += qs[e] * kv.x + qs[e + 1] * kv.y + qs[e + 2] * kv.z + qs[e + 3] * kv.w; }
        d = d * 0.125f + (Ft - F[(size_t)k * 8 + h]); sc[k] = d; mx = fmaxf(mx, d);
    }
    mx = wave_max(mx);
    float den = 0.f;
    for (int k = lane; k <= t; k += 64) { const float p = expf(sc[k] - mx); sc[k] = p; den += p; }
    den = wave_sum(den);
    __syncthreads();
    float o = 0.f;
    for (int k = 0; k <= t; ++k) o += (sc[k] / den) * proj[(size_t)k * INC + O_VB + h * 64 + lane];
    outB[(size_t)t * 512 + h * 64 + lane] = o;
}

__global__ void k_gate_merge(const float* proj, const float* PA, const float* PB, float* merged) {
    const int idx = blockIdx.x * blockDim.x + threadIdx.x;
    if (idx >= SEQ * DM) return;
    const int t = idx >> 10, c = idx & 1023;
    const float ga = proj[(size_t)t * INC + O_GA + c], gb = proj[(size_t)t * INC + O_GB + c];
    merged[idx] = PA[idx] / (1.0f + expf(-ga)) + PB[idx] / (1.0f + expf(-gb));
}

__global__ void k_swiglu(const float* gate, const float* up, float* u, int n) {
    const int idx = blockIdx.x * blockDim.x + threadIdx.x;
    if (idx >= n) return;
    const float g = gate[idx];
    u[idx] = (g / (1.0f + expf(-g))) * up[idx];
}

static void gemm(const float* A, const float* W, float* C, int M, int N, int K, hipStream_t st) {
    dim3 grid((N + 63) / 64, M / 64);
    k_gemm<<<grid, 256, 0, st>>>(A, W, C, M, N, K);
}

extern "C" void kernel_launch(void* const* d_in, const int* in_sizes, int n_in, void* d_out, int out_size, void* d_ws, size_t ws_size, hipStream_t stream) {
    const float* x = (const float*)d_in[0];
    const float* w_in = (const float*)d_in[1];
    const float* w_a = (const float*)d_in[2];
    const float* w_b = (const float*)d_in[3];
    const float* w_out = (const float*)d_in[4];
    const float* b_forget = (const float*)d_in[5];
    const float* w_gate = (const float*)d_in[6];
    const float* w_up = (const float*)d_in[7];
    const float* w_down = (const float*)d_in[8];
    const float* n_mix_pre = (const float*)d_in[9];
    const float* n_mix_post = (const float*)d_in[10];
    const float* n_ffn_pre = (const float*)d_in[11];
    const float* n_ffn_post = (const float*)d_in[12];
    float* out = (float*)d_out;
    float* ws = (float*)d_ws;
    size_t off = 0;
    auto take = [&](size_t n) { float* p = ws + off; off += (n + 63) / 64 * 64; return p; };
    float* cs = take(SEQ * 8); float* sn = take(SEQ * 8);
    float* h = take((size_t)SEQ * DM);
    float* proj = take((size_t)SEQ * INC);
    float* F = take(SEQ * 8);
    float* oA = take((size_t)3 * SEQ * 256); float* lseA = take(3 * SEQ * 4);
    float* outA = take((size_t)SEQ * 256); float* outB = take((size_t)SEQ * 512);
    float* PA = take((size_t)SEQ * DM); float* PB = take((size_t)SEQ * DM);
    float* merged = take((size_t)SEQ * DM); float* mix = take((size_t)SEQ * DM);
    float* h2 = take((size_t)SEQ * DM);
    float* gate = take((size_t)SEQ * DFF); float* up = take((size_t)SEQ * DFF); float* u = take((size_t)SEQ * DFF);
    float* ff = take((size_t)SEQ * DM);
    k_rope_table<<<(SEQ * 8 + 255) / 256, 256, 0, stream>>>(cs, sn);
    for (int b = 0; b < NB; ++b) {
        const float* xb = x + (size_t)b * SEQ * DM; float* ob = out + (size_t)b * SEQ * DM;
        k_rmsnorm<<<SEQ / 4, 256, 0, stream>>>(xb, n_mix_pre, nullptr, h, SEQ);
        gemm(h, w_in, proj, SEQ, INC, DM, stream);
        k_rope<<<(SEQ * 24 * 8 + 255) / 256, 256, 0, stream>>>(proj, cs, sn);
        k_logf_cumsum<<<8, 64, 0, stream>>>(proj, b_forget, F);
        k_dil_attn<<<dim3(SEQ, 12), 64, 0, stream>>>(proj, oA, lseA);
        k_merge_a<<<(SEQ * 256 + 255) / 256, 256, 0, stream>>>(oA, lseA, outA);
        k_fox_attn<<<dim3(SEQ, 8), 64, 0, stream>>>(proj, F, outB);
        gemm(outA, w_a, PA, SEQ, DM, 256, stream);
        gemm(outB, w_b, PB, SEQ, DM, 512, stream);
        k_gate_merge<<<(SEQ * DM + 255) / 256, 256, 0, stream>>>(proj, PA, PB, merged);
        gemm(merged, w_out, mix, SEQ, DM, DM, stream);
        k_rmsnorm<<<SEQ / 4, 256, 0, stream>>>(mix, n_mix_post, xb, ob, SEQ);
        k_rmsnorm<<<SEQ / 4, 256, 0, stream>>>(ob, n_ffn_pre, nullptr, h2, SEQ);
        gemm(h2, w_gate, gate, SEQ, DFF, DM, stream);
        gemm(h2, w_up, up, SEQ, DFF, DM, stream);
        k_swiglu<<<(SEQ * DFF + 255) / 256, 256, 0, stream>>>(gate, up, u, SEQ * DFF);
        gemm(u, w_down, ff, SEQ, DM, DFF, stream);
        k_rmsnorm<<<SEQ / 4, 256, 0, stream>>>(ff, n_ffn_post, ob, ob, SEQ);
    }
}
```
